# Optimizing an MI355X kernel written in HIP

```python
import math
import jax, jax.numpy as jnp
from jax import lax
import numpy as np

D_MODEL = 1024
BATCH = 16
SEQ = 2048
DEPTH = 1

SSD_HEADS = 16
SSD_HEAD_DIM = 64
SSD_INNER = SSD_HEADS * SSD_HEAD_DIM
SSD_GROUPS = 2
SSD_STATE = 128
SSD_CONV = 4
SSD_CHUNK = 128
SSD_CONV_CH = SSD_INNER + 2 * SSD_GROUPS * SSD_STATE
MLA_HEADS = 16
MLA_Q_RANK = 384
MLA_KV_RANK = 256
MLA_NOPE = 64
MLA_ROPE = 32
MLA_V = 64
MLA_QK = MLA_NOPE + MLA_ROPE
ROPE_THETA = 10000.0
Q_BLOCK = 128
MEM_LEN = 256
XA_HEADS = 4
XA_HEAD_DIM = D_MODEL // XA_HEADS
D_FF = 2816
FFN_RES_WEIGHT = 0.5
N_BRANCHES = 2
EPS = 1e-6
IN_SIZES = (SSD_INNER, SSD_CONV_CH, SSD_HEADS, MLA_Q_RANK, MLA_KV_RANK, MLA_ROPE, N_BRANCHES * D_MODEL)
D_IN = SSD_INNER + SSD_CONV_CH + SSD_HEADS + MLA_Q_RANK + MLA_KV_RANK + MLA_ROPE + N_BRANCHES * D_MODEL

kernel_name = "hybrid_ssd_mla_gated_macaron"


def _split_points(sizes):
    pts, acc = [], 0
    for sz in sizes[:-1]:
        acc += sz
        pts.append(acc)
    return pts


def rms_norm(x, g):
    xf = x.astype(jnp.float32)
    y = xf * lax.rsqrt(jnp.mean(xf * xf, axis=-1, keepdims=True) + EPS)
    return (y * g.astype(jnp.float32)).astype(x.dtype)


def swiglu(h, w_gate, w_up, w_down):
    return (jax.nn.silu(h @ w_gate) * (h @ w_up)) @ w_down


def rope_cos_sin(positions, dim):
    inv = ROPE_THETA ** (-jnp.arange(0, dim, 2, dtype=jnp.float32) / dim)
    ang = positions.astype(jnp.float32)[..., None] * inv
    return jnp.cos(ang), jnp.sin(ang)


def apply_rope(x, cos, sin):
    x1, x2 = jnp.split(x.astype(jnp.float32), 2, axis=-1)
    return jnp.concatenate([x1 * cos - x2 * sin, x1 * sin + x2 * cos], axis=-1).astype(x.dtype)


def causal_depthwise_conv(u, w, b):
    out = lax.conv_general_dilated(u, w[:, None, :], window_strides=(1,),
                                   padding=((SSD_CONV - 1, 0),),
                                   dimension_numbers=('NWC', 'WIO', 'NWC'),
                                   feature_group_count=u.shape[-1])
    return out + b


def segsum(a):
    L = a.shape[-1]
    cs = jnp.cumsum(a, axis=-1)
    diff = cs[..., :, None] - cs[..., None, :]
    mask = jnp.tril(jnp.ones((L, L), dtype=bool))
    return jnp.where(mask, diff, -jnp.inf)


def ssd_chunked(xh, dt, a, bm, cm):
    bsz, s, h, p = xh.shape
    g, n = bm.shape[-2:]
    r = h // g
    L = SSD_CHUNK
    c = s // L
    f32 = jnp.float32
    xdt = (xh.astype(f32) * dt[..., None]).reshape(bsz, c, L, g, r, p)
    adt = (dt * a).reshape(bsz, c, L, g, r).transpose(0, 3, 4, 1, 2)
    bm = bm.astype(f32).reshape(bsz, c, L, g, n)
    cm = cm.astype(f32).reshape(bsz, c, L, g, n)
    a_cs = jnp.cumsum(adt, axis=-1)
    decay = jnp.exp(segsum(adt))
    cb = jnp.einsum('bclgn,bcsgn->bcgls', cm, bm)
    y_diag = jnp.einsum('bcgls,bgrcls,bcsgrp->bclgrp', cb, decay, xdt)
    decay_states = jnp.exp(a_cs[..., -1:] - a_cs)
    states = jnp.einsum('bclgn,bgrcl,bclgrp->bcgrpn', bm, decay_states, xdt)
    chunk_decay = jnp.exp(a_cs[..., -1])

    def step(carry, inp):
        st, dec = inp
        return carry * dec[..., None, None] + st, carry

    init = jnp.zeros((bsz, g, r, p, n), f32)
    _, prev = lax.scan(step, init, (states.transpose(1, 0, 2, 3, 4, 5), chunk_decay.transpose(3, 0, 1, 2)))
    prev = prev.transpose(1, 0, 2, 3, 4, 5)
    y_off = jnp.einsum('bclgn,bcgrpn,bgrcl->bclgrp', cm, prev, jnp.exp(a_cs))
    return (y_diag + y_off).reshape(bsz, s, h, p)


def causal_block_attention(q_nope, q_rope, k_nope, k_rope, v):
    bsz, s, h, _ = q_nope.shape
    nb = s // Q_BLOCK
    scale = MLA_QK ** -0.5
    kpos = jnp.arange(s)

    def blk(args):
        qn, qr, i = args
        sc = (jnp.einsum('bqhd,bkhd->bhqk', qn, k_nope)
              + jnp.einsum('bqhd,bkd->bhqk', qr, k_rope)).astype(jnp.float32) * scale
        qpos = i * Q_BLOCK + jnp.arange(Q_BLOCK)
        sc = jnp.where(kpos[None, :] <= qpos[:, None], sc, -jnp.inf)
        pr = jax.nn.softmax(sc, axis=-1).astype(v.dtype)
        return jnp.einsum('bhqk,bkhd->bqhd', pr, v)

    def to_blocks(t):
        return t.reshape(bsz, nb, Q_BLOCK, *t.shape[2:]).swapaxes(0, 1)

    out = lax.map(blk, (to_blocks(q_nope), to_blocks(q_rope), jnp.arange(nb)))
    return out.swapaxes(0, 1).reshape(bsz, s, h, -1)


def hybrid_mixer(h, positions, w_in, conv_w, conv_b, dt_bias, a_log, d_skip, ssd_norm_g, w_ssd_proj,
                 q_norm_g, w_uq, kv_norm_g, w_uk, w_uv, w_mla_proj, gate_bias, w_out):
    bsz, s, _ = h.shape
    f32 = jnp.float32
    proj = h @ w_in
    z, xbc, dt_raw, q_c, kv_c, k_r, gate_logits = jnp.split(proj, _split_points(IN_SIZES), axis=-1)

    xbc = jax.nn.silu(causal_depthwise_conv(xbc, conv_w, conv_b))
    xs, bm, cm = jnp.split(xbc, [SSD_INNER, SSD_INNER + SSD_GROUPS * SSD_STATE], axis=-1)
    xs = xs.reshape(bsz, s, SSD_HEADS, SSD_HEAD_DIM)
    bm = bm.reshape(bsz, s, SSD_GROUPS, SSD_STATE)
    cm = cm.reshape(bsz, s, SSD_GROUPS, SSD_STATE)
    dt = jax.nn.softplus((dt_raw + dt_bias).astype(f32))
    a = -jnp.exp(a_log.astype(f32))
    y = ssd_chunked(xs, dt, a, bm, cm) + d_skip.astype(f32)[:, None] * xs.astype(f32)
    y = y.reshape(bsz, s, SSD_INNER).astype(h.dtype) * jax.nn.silu(z)
    y = rms_norm(y.reshape(bsz, s, SSD_GROUPS, -1), ssd_norm_g.reshape(SSD_GROUPS, -1)).reshape(bsz, s, SSD_INNER)
    y_ssd = y @ w_ssd_proj

    cos, sin = rope_cos_sin(positions, MLA_ROPE)
    q = (rms_norm(q_c, q_norm_g) @ w_uq).reshape(bsz, s, MLA_HEADS, MLA_QK)
    q_nope = q[..., :MLA_NOPE]
    q_rope = apply_rope(q[..., MLA_NOPE:], cos[:, :, None], sin[:, :, None])
    kv_c = rms_norm(kv_c, kv_norm_g)
    k_nope = (kv_c @ w_uk).reshape(bsz, s, MLA_HEADS, MLA_NOPE)
    v = (kv_c @ w_uv).reshape(bsz, s, MLA_HEADS, MLA_V)
    k_rope = apply_rope(k_r, cos, sin)
    o = causal_block_attention(q_nope, q_rope, k_nope, k_rope, v).reshape(bsz, s, MLA_HEADS * MLA_V)
    y_mla = o @ w_mla_proj

    gates = jax.nn.sigmoid((gate_logits + gate_bias).astype(f32)).astype(h.dtype)
    g_ssd, g_mla = jnp.split(gates, N_BRANCHES, axis=-1)
    return (g_ssd * y_ssd + g_mla * y_mla) @ w_out


def memory_cross_attention(h, mem_n, w_q, w_k, w_v, w_o):
    bsz, s, _ = h.shape
    q = (h @ w_q).reshape(bsz, s, XA_HEADS, XA_HEAD_DIM)
    k = (mem_n @ w_k).reshape(bsz, -1, XA_HEADS, XA_HEAD_DIM)
    v = (mem_n @ w_v).reshape(bsz, -1, XA_HEADS, XA_HEAD_DIM)
    sc = jnp.einsum('bqhd,bkhd->bhqk', q, k).astype(jnp.float32) * (XA_HEAD_DIM ** -0.5)
    pr = jax.nn.softmax(sc, axis=-1).astype(v.dtype)
    o = jnp.einsum('bhqk,bkhd->bqhd', pr, v).reshape(bsz, s, D_MODEL)
    return o @ w_o


def setup_inputs(seed: int = 0) -> dict:
    key = jax.random.key(seed)
    keys = iter(jax.random.split(key, 48))
    f32 = jnp.float32

    def dense(fan_in, *shape):
        return jax.random.normal(next(keys), (DEPTH,) + shape, f32) * fan_in ** -0.5

    def gain(*shape):
        return 1.0 + 0.02 * jax.random.normal(next(keys), (DEPTH,) + shape, f32)

    def small(*shape):
        return 0.01 * jax.random.normal(next(keys), (DEPTH,) + shape, f32)

    x = jax.random.normal(next(keys), (BATCH, SEQ, D_MODEL), f32)
    mem = jax.random.normal(next(keys), (BATCH, MEM_LEN, D_MODEL), f32)
    offset = jax.random.randint(next(keys), (BATCH, 1), 0, 1024, dtype=jnp.int32)
    positions = (offset + jnp.arange(SEQ, dtype=jnp.int32)[None, :]).astype(jnp.int32)

    u = jax.random.uniform(next(keys), (DEPTH, SSD_HEADS), f32)
    dt0 = jnp.exp(u * (math.log(0.1) - math.log(0.001)) + math.log(0.001))
    dt_bias = dt0 + jnp.log(-jnp.expm1(-dt0))
    a_log = jnp.log(jax.random.uniform(next(keys), (DEPTH, SSD_HEADS), f32, minval=1.0, maxval=16.0))

    return {
        "x": x, "mem": mem, "positions": positions,
        "ffn1_pre_g": gain(D_MODEL), "ffn1_w_gate": dense(D_MODEL, D_MODEL, D_FF),
        "ffn1_w_up": dense(D_MODEL, D_MODEL, D_FF), "ffn1_w_down": dense(D_FF, D_FF, D_MODEL),
        "ffn1_post_g": gain(D_MODEL),
        "mix_pre_g": gain(D_MODEL), "w_in": dense(D_MODEL, D_MODEL, D_IN),
        "conv_w": dense(SSD_CONV, SSD_CONV, SSD_CONV_CH), "conv_b": small(SSD_CONV_CH),
        "dt_bias": dt_bias, "a_log": a_log,
        "d_skip": 1.0 + 0.1 * jax.random.normal(next(keys), (DEPTH, SSD_HEADS), f32),
        "ssd_norm_g": gain(SSD_INNER), "w_ssd_proj": dense(SSD_INNER, SSD_INNER, D_MODEL),
        "q_norm_g": gain(MLA_Q_RANK), "w_uq": dense(MLA_Q_RANK, MLA_Q_RANK, MLA_HEADS * MLA_QK),
        "kv_norm_g": gain(MLA_KV_RANK), "w_uk": dense(MLA_KV_RANK, MLA_KV_RANK, MLA_HEADS * MLA_NOPE),
        "w_uv": dense(MLA_KV_RANK, MLA_KV_RANK, MLA_HEADS * MLA_V),
        "w_mla_proj": dense(MLA_HEADS * MLA_V, MLA_HEADS * MLA_V, D_MODEL),
        "gate_bias": small(N_BRANCHES * D_MODEL), "w_out": dense(D_MODEL, D_MODEL, D_MODEL),
        "mix_post_g": gain(D_MODEL),
        "xa_pre_g": gain(D_MODEL), "mem_norm_g": gain(D_MODEL),
        "w_xq": dense(D_MODEL, D_MODEL, D_MODEL), "w_xk": dense(D_MODEL, D_MODEL, D_MODEL),
        "w_xv": dense(D_MODEL, D_MODEL, D_MODEL), "w_xo": dense(D_MODEL, D_MODEL, D_MODEL),
        "xa_post_g": gain(D_MODEL),
        "ffn2_pre_g": gain(D_MODEL), "ffn2_w_gate": dense(D_MODEL, D_MODEL, D_FF),
        "ffn2_w_up": dense(D_MODEL, D_MODEL, D_FF), "ffn2_w_down": dense(D_FF, D_FF, D_MODEL),
        "ffn2_post_g": gain(D_MODEL),
    }


def reference(x, mem, positions, ffn1_pre_g, ffn1_w_gate, ffn1_w_up, ffn1_w_down, ffn1_post_g,
              mix_pre_g, w_in, conv_w, conv_b, dt_bias, a_log, d_skip, ssd_norm_g, w_ssd_proj,
              q_norm_g, w_uq, kv_norm_g, w_uk, w_uv, w_mla_proj, gate_bias, w_out, mix_post_g,
              xa_pre_g, mem_norm_g, w_xq, w_xk, w_xv, w_xo, xa_post_g,
              ffn2_pre_g, ffn2_w_gate, ffn2_w_up, ffn2_w_down, ffn2_post_g):
    for l in range(DEPTH):
        h = swiglu(rms_norm(x, ffn1_pre_g[l]), ffn1_w_gate[l], ffn1_w_up[l], ffn1_w_down[l])
        x = x + FFN_RES_WEIGHT * rms_norm(h, ffn1_post_g[l])
        h = hybrid_mixer(rms_norm(x, mix_pre_g[l]), positions, w_in[l], conv_w[l], conv_b[l], dt_bias[l],
                         a_log[l], d_skip[l], ssd_norm_g[l], w_ssd_proj[l], q_norm_g[l], w_uq[l],
                         kv_norm_g[l], w_uk[l], w_uv[l], w_mla_proj[l], gate_bias[l], w_out[l])
        x = x + rms_norm(h, mix_post_g[l])
        h = memory_cross_attention(rms_norm(x, xa_pre_g[l]), rms_norm(mem, mem_norm_g[l]),
                                   w_xq[l], w_xk[l], w_xv[l], w_xo[l])
        x = x + rms_norm(h, xa_post_g[l])
        h = swiglu(rms_norm(x, ffn2_pre_g[l]), ffn2_w_gate[l], ffn2_w_up[l], ffn2_w_down[l])
        x = x + FFN_RES_WEIGHT * rms_norm(h, ffn2_post_g[l])
    return x
```

```cpp
#include <hip/hip_runtime.h>
#include <hip/hip_bf16.h>
#include <cstdio>
#include <cstdint>

#define GAS __attribute__((address_space(1)))
#define LAS __attribute__((address_space(3)))
typedef unsigned short bf16;
typedef unsigned v4u __attribute__((ext_vector_type(4)));
typedef unsigned v2u __attribute__((ext_vector_type(2)));
typedef float f32x4 __attribute__((ext_vector_type(4)));
typedef float f32x2 __attribute__((ext_vector_type(2)));
typedef float f32x16 __attribute__((ext_vector_type(16)));
typedef short bf16x8 __attribute__((ext_vector_type(8)));
typedef short s16x4 __attribute__((ext_vector_type(4)));

constexpr int BATCH = 16, SEQ = 2048, DM = 1024, T = BATCH * SEQ;
constexpr int DFF = 2816, MEMLEN = 256, MROWS = BATCH * MEMLEN;
constexpr int NWIN = 3328;
constexpr int MISC_LD = 688;
constexpr float EPS = 1e-6f;
constexpr float LOG2E = 1.4426950408889634f;
constexpr float C2_MLA = 0.14724444602590306f;
constexpr float C2_XA = 0.09016844005556021f;
constexpr int NWAVES = 8;

constexpr size_t MiB = 1u << 20;
constexpr size_t WS_CTL = 0, CTL_ZERO_BYTES = 1 * MiB;
constexpr size_t WS_ROPE = 1 * MiB;
constexpr size_t WS_MEMN = 5 * MiB;
constexpr size_t WS_MK = 13 * MiB;
constexpr size_t WS_MVT = 21 * MiB;
constexpr size_t WS_DT = 29 * MiB;
constexpr size_t WS_KR = 31 * MiB;
constexpr size_t WS_W = 33 * MiB;
constexpr size_t W_GU1 = WS_W;
constexpr size_t W_D1 = W_GU1 + (size_t)5632 * 1024 * 2;
constexpr size_t W_IN = W_D1 + (size_t)1024 * 2816 * 2;
constexpr size_t W_G = W_IN + (size_t)NWIN * 1024 * 2;
constexpr size_t W_SSD = W_G + (size_t)2048 * 1024 * 2;
constexpr size_t W_MLA = W_SSD + (size_t)1024 * 1024 * 2;
constexpr size_t W_OUT = W_MLA + (size_t)1024 * 1024 * 2;
constexpr size_t W_XQ = W_OUT + (size_t)1024 * 1024 * 2;
constexpr size_t W_XK = W_XQ + (size_t)1024 * 1024 * 2;
constexpr size_t W_XV = W_XK + (size_t)1024 * 1024 * 2;
constexpr size_t W_XO = W_XV + (size_t)1024 * 1024 * 2;
constexpr size_t W_UQ = W_XO + (size_t)1024 * 1024 * 2;
constexpr size_t W_UKV = W_UQ + (size_t)1536 * 384 * 2;
constexpr size_t W_GU2 = W_UKV + (size_t)2048 * 256 * 2;
constexpr size_t W_D2 = W_GU2 + (size_t)5632 * 1024 * 2;
constexpr size_t W_END = W_D2 + (size_t)1024 * 2816 * 2;
static_assert(W_END <= 96 * MiB, "weights fit below the activation region");
constexpr size_t WS_XN = 96 * MiB;
constexpr size_t WS_HID = 160 * MiB;
constexpr size_t WS_ZS = 160 * MiB;
constexpr size_t WS_XBC = 224 * MiB;
constexpr size_t WS_MISC = 320 * MiB;
constexpr size_t WS_QN = 406 * MiB;
constexpr size_t WS_KVN = 430 * MiB;
constexpr size_t WS_YG = 446 * MiB;
constexpr size_t WS_QNOPE = 160 * MiB;
constexpr size_t WS_KN = 224 * MiB;
constexpr size_t WS_V = 288 * MiB;
constexpr size_t WS_QROPE = 352 * MiB;
constexpr size_t WS_G = 224 * MiB;
constexpr size_t WS_MERGED = 352 * MiB;
constexpr size_t WS_QX = 160 * MiB;
constexpr size_t WS_P = 224 * MiB;
constexpr size_t WS_OX = 288 * MiB;
constexpr size_t WS_END = 512 * MiB;
static_assert(WS_YG + (size_t)T * 1024 * 2 <= WS_END, "ws map");
constexpr int CW_BAR = 4096;

constexpr int RING_BYTES = 131072;
constexpr int LDSCTL_OFF = RING_BYTES, MISC_OFF = LDSCTL_OFF + 320;
constexpr int LDS_BYTES = 147456;

#define RLX_AGENT __ATOMIC_RELAXED, __HIP_MEMORY_SCOPE_AGENT
#define LDS_WAIT() asm volatile("s_waitcnt lgkmcnt(0)" ::: "memory")
#define VM_WAIT() asm volatile("s_waitcnt vmcnt(0)" ::: "memory")
__device__ __forceinline__ unsigned f2bf(float f) { unsigned u = __builtin_bit_cast(unsigned, f); return (u + 0x7fffu + ((u >> 16) & 1u)) >> 16; }
__device__ __forceinline__ unsigned pk2(float lo, float hi) { return f2bf(lo) | (f2bf(hi) << 16); }
typedef __bf16 bf16x2_t __attribute__((ext_vector_type(2)));
__device__ __forceinline__ unsigned cvt_pk_bf16(float lo, float hi) { const f32x2 v = {lo, hi}; const bf16x2_t b = __builtin_convertvector(v, bf16x2_t); return __builtin_bit_cast(unsigned, b); }
__device__ __forceinline__ float bf_lo(unsigned u) { return __builtin_bit_cast(float, u << 16); }
__device__ __forceinline__ float bf_hi(unsigned u) { return __builtin_bit_cast(float, u & 0xffff0000u); }
__device__ __forceinline__ float fast_exp2(float x) { return __builtin_amdgcn_exp2f(x); }
__device__ __forceinline__ float fast_rcp(float x) { return __builtin_amdgcn_rcpf(x); }
__device__ __forceinline__ float silu_f(float v) { return v * fast_rcp(1.0f + fast_exp2(-v * LOG2E)); }
__device__ __forceinline__ float sigmoid_f(float v) { return fast_rcp(1.0f + fast_exp2(-v * LOG2E)); }
__device__ __forceinline__ float wave_sum(float v) {
#pragma unroll
    for (int o = 1; o < 64; o <<= 1) v += __shfl_xor(v, o);
    return v;
}

namespace pg8 {
typedef unsigned short bf16_t;
typedef unsigned u32x4 __attribute__((ext_vector_type(4)));
constexpr int BM = 256, BK = 64, HALF = 128, HTB = HALF * BK * 2, STAGE_BYTES = 8 * HTB, NXCD = 8, WGM = 8;

__host__ __device__ __forceinline__ int lds_byte(int r, int c) { const int st = (r >> 4) * 2 + (c >> 5), rr = r & 15, cc = c & 31, ob = rr * 64 + cc * 2; return st * 1024 + (ob ^ (((ob >> 9) & 1) << 5)); }
__host__ __device__ __forceinline__ void stage_rc(int b, int& R, int& C) { const int st = b / 1024, sb = b % 1024, swz = sb ^ (((sb >> 9) & 1) << 5); R = (st >> 1) * 16 + swz / 64; C = (st & 1) * 32 + (swz % 64) / 2; }
__host__ __device__ __forceinline__ int perm32(int rho) { const int n = rho >> 4, i = rho & 15; return 8 * (i >> 2) + 4 * n + (i & 3); }

struct Unit { int pm, pn; unsigned aoff, boff; };
struct Gemm { const bf16_t* A; const bf16_t* Bt; int lda, ldb, K; };

struct StaticOrder {
    int nM, nN, nwg, G, c; unsigned astep, bstep;
    __device__ void init(int M, int N, int G_, int c_, int lda, int ldb) { nM = M / BM; nN = N / BM; nwg = nM * nN; G = G_; c = c_; astep = (unsigned)(BM * lda * 2); bstep = (unsigned)(BM * ldb * 2); }
    __device__ bool next(int i, Unit& u) const {
        const long L = (long)i * G + c; if (L >= nwg) return false;
        int wgid = (int)L; { const int q = nwg / NXCD, r = nwg % NXCD, xcd = wgid % NXCD, off = wgid / NXCD; wgid = (xcd < r ? xcd * (q + 1) : r * (q + 1) + (xcd - r) * q) + off; }
        const int nig = WGM * nN, gid = wgid / nig, fm = gid * WGM, gsz = (nM - fm) < WGM ? (nM - fm) : WGM;
        u.pm = fm + ((wgid % nig) % gsz); u.pn = (wgid % nig) / gsz; u.aoff = (unsigned)u.pm * astep; u.boff = (unsigned)u.pn * bstep; return true;
    }
};
template <int MODE> struct XaOrder {
    int G, vcu;
    __device__ bool next(int i, Unit& u) const {
        const int L = __builtin_amdgcn_readfirstlane(i * G + vcu); if (L >= 512) return false;
        const int z = L >> 3, pml = L & 7, b = z >> 2, h = z & 3;
        u.pm = b * 8 + pml; u.pn = h;
        u.aoff = (unsigned)((b * 2048 + pml * 256) * 1024 + h * 256) * 2u;
        u.boff = MODE == 0 ? (unsigned)((b * 256) * 1024 + h * 256) * 2u : (unsigned)((h * 256) * 4096 + b * 256) * 2u;
        return true;
    }
};

typedef f32x4 Acc[2][2][4][2];

template <class Epi, class Sched, bool ALIGN_EPI>
__device__ __forceinline__ void gemm_phase(LAS unsigned char* lds, const Gemm g, const Sched& S, const Epi& E) {
    int tid_ = threadIdx.x; asm volatile("" : "+v"(tid_));
    const int tid = tid_, wid = __builtin_amdgcn_readfirstlane(tid >> 6), lane = tid & 63, wr = wid >> 2, wc = wid & 3, fr = lane & 15, fq = lane >> 4;
    const int K = g.K, nt = K / BK;
    unsigned voffA[2], voffB[2];
#pragma unroll
    for (int i = 0; i < 2; ++i) { int R, C; stage_rc(tid * 16 + i * 8192, R, C); const int Rb = Epi::PERM ? ((R & ~31) + perm32(R & 31)) : R;
        voffA[i] = (unsigned)(R * g.lda + C) * 2u; voffB[i] = (unsigned)(Rb * g.ldb + C) * 2u; }
    const size_t kstep = (size_t)(BK * 2);
    const size_t hstepA = (size_t)HALF * g.lda * 2, hstepB = (size_t)HALF * g.ldb * 2;
    const unsigned ldsw = (unsigned)wid * 1024u;
    const int aoff = lds_byte(wr * 64 + fr, fq * 8), boff = lds_byte(wc * 32 + fr, fq * 8);
#define PG8_SA(b, h) (((b) * 2 + (h)) * HTB)
#define PG8_SB(b, h) ((4 + (b) * 2 + (h)) * HTB)
#define PG8_STAGE(bufoff, gbase, voff) do { _Pragma("unroll") for (int _i = 0; _i < 2; ++_i) \
        __builtin_amdgcn_global_load_lds((const unsigned*)((const char*)(gbase) + (voff)[_i]), (LAS unsigned*)(lds + (bufoff) + ldsw + _i * 8192), 16, 0, 0); } while (0)
#define PG8_LDA(dst, b, h) do { _Pragma("unroll") for (int m = 0; m < 4; ++m) _Pragma("unroll") for (int k = 0; k < 2; ++k) dst[m][k] = *(const LAS bf16x8*)(lds + PG8_SA(b, h) + aoff + m * 2048 + k * 1024); } while (0)
#define PG8_LDB(dst, b, h) do { _Pragma("unroll") for (int n = 0; n < 2; ++n) _Pragma("unroll") for (int k = 0; k < 2; ++k) dst[n][k] = *(const LAS bf16x8*)(lds + PG8_SB(b, h) + boff + n * 2048 + k * 1024); } while (0)
#define PG8_MMA(ai, bj, At, Bt) do { __builtin_amdgcn_s_setprio(1); _Pragma("unroll") for (int m = 0; m < 4; ++m) _Pragma("unroll") for (int n = 0; n < 2; ++n) _Pragma("unroll") for (int k = 0; k < 2; ++k) \
        acc[ai][bj][m][n] = __builtin_amdgcn_mfma_f32_16x16x32_bf16(Bt[n][k], At[m][k], acc[ai][bj][m][n], 0, 0, 0); __builtin_amdgcn_s_setprio(0); } while (0)
#define PG8_WAIT_V(n) asm volatile("s_waitcnt vmcnt(" #n ")" ::: "memory")
#define PG8_WAIT_L(n) asm volatile("s_waitcnt lgkmcnt(" #n ")" ::: "memory")
#define PG8_BAR __builtin_amdgcn_s_barrier()
#define PG8_SCHED __builtin_amdgcn_sched_barrier(0)
    Unit cur, nxt; int ui = 0;
    if (!S.next(0, cur)) return;
    Acc acc;
#pragma unroll
    for (int a = 0; a < 2; ++a)
#pragma unroll
        for (int b = 0; b < 2; ++b)
#pragma unroll
            for (int m = 0; m < 4; ++m)
#pragma unroll
                for (int n = 0; n < 2; ++n) acc[a][b][m][n] = (f32x4){0.f, 0.f, 0.f, 0.f};
    bf16x8 At[4][2], B0[2][2], B1[2][2];
    const char* cA = (const char*)g.A + cur.aoff; const char* cB = (const char*)g.Bt + cur.boff;
    PG8_STAGE(PG8_SB(0, 0), cB, voffB); PG8_STAGE(PG8_SB(0, 1), cB + hstepB, voffB); PG8_STAGE(PG8_SA(0, 0), cA, voffA); PG8_STAGE(PG8_SA(0, 1), cA + hstepA, voffA);
    if (wr == 1) PG8_BAR;
    PG8_WAIT_V(2); PG8_BAR;
    PG8_STAGE(PG8_SB(1, 0), cB + kstep, voffB); PG8_STAGE(PG8_SA(1, 0), cA + kstep, voffA); PG8_STAGE(PG8_SB(1, 1), cB + hstepB + kstep, voffB);
    PG8_WAIT_V(6); PG8_BAR;
    for (;;) {
        const bool has_next = S.next(ui + 1, nxt);
        const char* nA = has_next ? (const char*)g.A + nxt.aoff : cA; const char* nB = has_next ? (const char*)g.Bt + nxt.boff : cB;
#pragma nounroll
        for (int t = 0; t < nt; t += 2) {
            const bool last = (t == nt - 2);
            const char* a1 = cA + (size_t)(t + 1) * kstep;
            const char* a2 = last ? nA : cA + (size_t)(t + 2) * kstep; const char* b2 = last ? nB : cB + (size_t)(t + 2) * kstep;
            const char* a3 = a2 + kstep; const char* b3 = b2 + kstep;
            PG8_LDB(B0, 0, 0); PG8_LDB(B1, 0, 1); PG8_SCHED; PG8_LDA(At, 0, 0); PG8_STAGE(PG8_SA(1, 1), a1 + hstepA, voffA);
            PG8_WAIT_V(8); PG8_WAIT_L(0); PG8_BAR; PG8_MMA(0, 0, At, B0); PG8_MMA(0, 1, At, B1); PG8_BAR; PG8_SCHED;
            PG8_LDA(At, 0, 1); PG8_STAGE(PG8_SB(0, 0), b2, voffB); PG8_STAGE(PG8_SB(0, 1), b2 + hstepB, voffB); PG8_STAGE(PG8_SA(0, 0), a2, voffA);
            PG8_WAIT_V(8); PG8_WAIT_L(0); PG8_BAR; PG8_MMA(1, 0, At, B0); PG8_MMA(1, 1, At, B1); PG8_BAR; PG8_SCHED;
            PG8_LDB(B0, 1, 0); PG8_LDB(B1, 1, 1); PG8_SCHED; PG8_LDA(At, 1, 0); PG8_STAGE(PG8_SA(0, 1), a2 + hstepA, voffA);
            PG8_WAIT_V(8); PG8_WAIT_L(0); PG8_BAR; PG8_MMA(0, 0, At, B0); PG8_MMA(0, 1, At, B1); PG8_BAR; PG8_SCHED;
            PG8_LDA(At, 1, 1); PG8_STAGE(PG8_SB(1, 0), b3, voffB); PG8_STAGE(PG8_SB(1, 1), b3 + hstepB, voffB); PG8_STAGE(PG8_SA(1, 0), a3, voffA);
            PG8_WAIT_V(8); PG8_WAIT_L(0); PG8_BAR; PG8_MMA(1, 0, At, B0); PG8_MMA(1, 1, At, B1); PG8_BAR; PG8_SCHED;
        }
        if constexpr (ALIGN_EPI) { if (wr == 0) PG8_BAR; }
        if constexpr (!Epi::AFTER_DRAIN) { E(acc, cur, wr, wc, fr, fq); }
        if (!has_next) break;
#pragma unroll
        for (int a = 0; a < 2; ++a)
#pragma unroll
            for (int b = 0; b < 2; ++b)
#pragma unroll
                for (int m = 0; m < 4; ++m)
#pragma unroll
                    for (int n = 0; n < 2; ++n) acc[a][b][m][n] = (f32x4){0.f, 0.f, 0.f, 0.f};
        cur = nxt; cA = nA; cB = nB; ++ui;
        if constexpr (ALIGN_EPI) { if (wr == 1) PG8_BAR; }
    }
    PG8_WAIT_V(0);
    if constexpr (!ALIGN_EPI) { if (wr == 0) PG8_BAR; }
    PG8_BAR;
    if constexpr (Epi::AFTER_DRAIN) { E.fused(acc, cur, wr, wc, fr, fq, lds, wid, lane); }
#undef PG8_SA
#undef PG8_SB
#undef PG8_STAGE
#undef PG8_LDA
#undef PG8_LDB
#undef PG8_MMA
#undef PG8_WAIT_V
#undef PG8_WAIT_L
#undef PG8_BAR
#undef PG8_SCHED
}

#define EPI_ROWS_BEGIN  _Pragma("unroll") for (int ai = 0; ai < 2; ++ai) _Pragma("unroll") for (int m = 0; m < 4; ++m) { const size_t row = (size_t)(u.pm * BM + ai * HALF + wr * 64 + m * 16 + fr);
#define EPI_ROWS_END    }
__device__ __forceinline__ u32x4 pack8(f32x4 v0, f32x4 v1) { u32x4 w; w.x = cvt_pk_bf16(v0[0], v0[1]); w.y = cvt_pk_bf16(v0[2], v0[3]); w.z = cvt_pk_bf16(v1[0], v1[1]); w.w = cvt_pk_bf16(v1[2], v1[3]); return w; }
__device__ __forceinline__ void unpack8(u32x4 w, f32x4& v0, f32x4& v1) { v0 = (f32x4){bf_lo(w.x), bf_hi(w.x), bf_lo(w.y), bf_hi(w.y)}; v1 = (f32x4){bf_lo(w.z), bf_hi(w.z), bf_lo(w.w), bf_hi(w.w)}; }

struct EpiBf16 {
    static constexpr bool PERM = true, AFTER_DRAIN = false;
    bf16_t* O0; int ld0; bf16_t* O1; int ld1; int t1; bf16_t* O2; int ld2; int t2; float scale;
    __device__ __forceinline__ void operator()(const Acc& acc, const Unit& u, int wr, int wc, int fr, int fq) const {
        bf16_t* base = O0; int ld = ld0, pn = u.pn;
        if (pn >= t2) { base = O2; ld = ld2; pn -= t2; } else if (pn >= t1) { base = O1; ld = ld1; pn -= t1; }
        const int col0 = pn * BM + wc * 32 + 8 * fq;
        EPI_ROWS_BEGIN
            bf16_t* rowp = base + row * ld + col0;
#pragma unroll
            for (int bj = 0; bj < 2; ++bj) *(u32x4*)(rowp + bj * HALF) = pack8(acc[ai][bj][m][0] * scale, acc[ai][bj][m][1] * scale);
        EPI_ROWS_END
    }
};
struct EpiSwiGLU {
    static constexpr bool PERM = true, AFTER_DRAIN = false;
    bf16_t* O; int ldc;
    __device__ __forceinline__ void operator()(const Acc& acc, const Unit& u, int wr, int wc, int fr, int fq) const {
        const int col0 = u.pn * HALF + wc * 32 + 8 * fq;
        EPI_ROWS_BEGIN
            f32x4 g0 = acc[ai][0][m][0], g1 = acc[ai][0][m][1], u0 = acc[ai][1][m][0], u1 = acc[ai][1][m][1];
#pragma unroll
            for (int e = 0; e < 4; ++e) { g0[e] = silu_f(g0[e]) * u0[e]; g1[e] = silu_f(g1[e]) * u1[e]; }
            *(u32x4*)(O + row * ldc + col0) = pack8(g0, g1);
        EPI_ROWS_END
    }
};
struct EpiWin {
    static constexpr bool PERM = true, AFTER_DRAIN = false;
    bf16_t* ZS; bf16_t* XBC; float* MISC;
    __device__ __forceinline__ void operator()(const Acc& acc, const Unit& u, int wr, int wc, int fr, int fq) const {
        const int pn = u.pn;
        if (pn < 4) {
            const int col0 = pn * BM + wc * 32 + 8 * fq;
            EPI_ROWS_BEGIN
#pragma unroll
                for (int bj = 0; bj < 2; ++bj) { f32x4 v0 = acc[ai][bj][m][0], v1 = acc[ai][bj][m][1];
#pragma unroll
                    for (int e = 0; e < 4; ++e) { v0[e] = silu_f(v0[e]); v1[e] = silu_f(v1[e]); }
                    *(u32x4*)(ZS + row * 1024 + col0 + bj * HALF) = pack8(v0, v1); }
            EPI_ROWS_END
        } else if (pn < 10) {
            const int col0 = (pn - 4) * BM + wc * 32 + 8 * fq;
            EPI_ROWS_BEGIN
#pragma unroll
                for (int bj = 0; bj < 2; ++bj) *(u32x4*)(XBC + row * 1536 + col0 + bj * HALF) = pack8(acc[ai][bj][m][0], acc[ai][bj][m][1]);
            EPI_ROWS_END
        } else {
            const int col0 = (pn - 10) * BM + wc * 32 + 8 * fq;
            EPI_ROWS_BEGIN
#pragma unroll
                for (int bj = 0; bj < 2; ++bj) { const int c = col0 + bj * HALF;
                    if (c + 8 <= MISC_LD) { float* p = MISC + row * MISC_LD + c; *(f32x4*)p = acc[ai][bj][m][0]; *(f32x4*)(p + 4) = acc[ai][bj][m][1]; } }
            EPI_ROWS_END
        }
    }
};
struct EpiGate {
    static constexpr bool PERM = true, AFTER_DRAIN = false;
    bf16_t* G; const float* bias;
    __device__ __forceinline__ void operator()(const Acc& acc, const Unit& u, int wr, int wc, int fr, int fq) const {
        const int col0 = u.pn * BM + wc * 32 + 8 * fq;
        f32x4 bv[2][2];
#pragma unroll
        for (int bj = 0; bj < 2; ++bj) { bv[bj][0] = *(const f32x4*)(bias + col0 + bj * HALF); bv[bj][1] = *(const f32x4*)(bias + col0 + bj * HALF + 4); }
        EPI_ROWS_BEGIN
#pragma unroll
            for (int bj = 0; bj < 2; ++bj) { f32x4 v0 = acc[ai][bj][m][0] + bv[bj][0], v1 = acc[ai][bj][m][1] + bv[bj][1];
#pragma unroll
                for (int e = 0; e < 4; ++e) { v0[e] = sigmoid_f(v0[e]); v1[e] = sigmoid_f(v1[e]); }
                *(u32x4*)(G + row * 2048 + col0 + bj * HALF) = pack8(v0, v1); }
        EPI_ROWS_END
    }
};
template <bool ADD> struct EpiMerge {
    static constexpr bool PERM = true, AFTER_DRAIN = false;
    bf16_t* Mg; const bf16_t* G; int goff;
    __device__ __forceinline__ void operator()(const Acc& acc, const Unit& u, int wr, int wc, int fr, int fq) const {
        const int col0 = u.pn * BM + wc * 32 + 8 * fq;
        EPI_ROWS_BEGIN
#pragma unroll
            for (int bj = 0; bj < 2; ++bj) {
                f32x4 g0, g1; unpack8(*(const u32x4*)(G + row * 2048 + goff + col0 + bj * HALF), g0, g1);
                f32x4 v0 = acc[ai][bj][m][0] * g0, v1 = acc[ai][bj][m][1] * g1;
                bf16_t* p = Mg + row * 1024 + col0 + bj * HALF;
                if (ADD) { f32x4 o0, o1; unpack8(*(const u32x4*)p, o0, o1); v0 += o0; v1 += o1; }
                *(u32x4*)p = pack8(v0, v1); }
        EPI_ROWS_END
    }
};
struct EpiSoftmax {
    static constexpr bool PERM = true, AFTER_DRAIN = true;
    bf16_t* P;
    __device__ __forceinline__ void fused(Acc& acc, const Unit& u, int wr, int wc, int fr, int fq, LAS unsigned char* lds, int wid, int lane) const {
        LAS float* PM = (LAS float*)lds;
        LAS float* PS = (LAS float*)(lds + 4096);
        float mx[2][4];
#pragma unroll
        for (int ai = 0; ai < 2; ++ai)
#pragma unroll
            for (int m = 0; m < 4; ++m) { float v = -3.0e38f;
#pragma unroll
                for (int bj = 0; bj < 2; ++bj)
#pragma unroll
                    for (int n = 0; n < 2; ++n) { const f32x4 x = acc[ai][bj][m][n]; v = fmaxf(v, fmaxf(fmaxf(x[0], x[1]), fmaxf(x[2], x[3]))); }
                v = fmaxf(v, __shfl_xor(v, 16)); v = fmaxf(v, __shfl_xor(v, 32));
                if (fq == 0) PM[(ai * HALF + wr * 64 + m * 16 + fr) * 4 + wc] = v; }
        asm volatile("s_waitcnt lgkmcnt(0)" ::: "memory"); __builtin_amdgcn_s_barrier(); asm volatile("" ::: "memory");
#pragma unroll
        for (int ai = 0; ai < 2; ++ai)
#pragma unroll
            for (int m = 0; m < 4; ++m) { const f32x4 q = *(const LAS f32x4*)(PM + (ai * HALF + wr * 64 + m * 16 + fr) * 4); const float rmax = fmaxf(fmaxf(q[0], q[1]), fmaxf(q[2], q[3]));
                float s = 0.f;
#pragma unroll
                for (int bj = 0; bj < 2; ++bj)
#pragma unroll
                    for (int n = 0; n < 2; ++n) { f32x4 x = acc[ai][bj][m][n];
#pragma unroll
                        for (int e = 0; e < 4; ++e) { x[e] = fast_exp2(x[e] - rmax); s += x[e]; }
                        acc[ai][bj][m][n] = x; }
                s += __shfl_xor(s, 16); s += __shfl_xor(s, 32);
                if (fq == 0) PS[(ai * HALF + wr * 64 + m * 16 + fr) * 4 + wc] = s;
                mx[ai][m] = 0.f; }
        asm volatile("s_waitcnt lgkmcnt(0)" ::: "memory"); __builtin_amdgcn_s_barrier(); asm volatile("" ::: "memory");
        const int col0 = u.pn * BM + wc * 32 + 8 * fq;
#pragma unroll
        for (int ai = 0; ai < 2; ++ai)
#pragma unroll
            for (int m = 0; m < 4; ++m) { const f32x4 q = *(const LAS f32x4*)(PS + (ai * HALF + wr * 64 + m * 16 + fr) * 4); const float inv = 1.0f / ((q[0] + q[1]) + (q[2] + q[3]));
                const size_t row = (size_t)(u.pm * BM + ai * HALF + wr * 64 + m * 16 + fr);
#pragma unroll
                for (int bj = 0; bj < 2; ++bj) *(u32x4*)(P + row * 1024 + col0 + bj * HALF) = pack8(acc[ai][bj][m][0] * inv, acc[ai][bj][m][1] * inv);
                (void)mx[ai][m]; }
        asm volatile("s_waitcnt lgkmcnt(0)" ::: "memory"); __builtin_amdgcn_s_barrier(); asm volatile("" ::: "memory");
    }
};
}

namespace mla {
constexpr int KPITCH = 208, KBYTES = 64 * KPITCH, VBYTES = 8192, BUFB = KBYTES + VBYTES;
constexpr int LDS_WS = 2 * BUFB, LDS_OST = LDS_WS + NWAVES * 256, LDS_TOTAL = LDS_OST + NWAVES * 4096;
static_assert(LDS_TOTAL <= RING_BYTES, "mla lds");
__device__ __forceinline__ int crow(int r, int hi) { return (r & 3) + 8 * (r >> 2) + 4 * hi; }
__device__ __forceinline__ s16x4 vtr(const LAS unsigned char* p) { typedef short v4i16_t __attribute__((ext_vector_type(4))); return __builtin_bit_cast(s16x4, __builtin_amdgcn_ds_read_tr16_b64_v4i16((LAS v4i16_t*)p)); }

__device__ __forceinline__ void attn_unit(int b, int h, int qb, const bf16* QNOPE, const bf16* QROPE, const bf16* KN, const bf16* KR, const bf16* V, const float* ROPE, bf16* O, LAS unsigned char* shm) {
    int tid_ = threadIdx.x; asm volatile("" : "+v"(tid_));
    const int tid = tid_, lane = tid & 63, r32 = lane & 31, hi = lane >> 5; const int wid = __builtin_amdgcn_readfirstlane(tid >> 6);
    const size_t rowbase = (size_t)b * SEQ; const int q0 = qb * 256;
    const size_t qrow = rowbase + q0 + wid * 32 + r32;
    LAS float* wsf = (LAS float*)(shm + LDS_WS) + wid * 64;
    bf16x8 qr[6];
#pragma unroll
    for (int d0 = 0; d0 < 4; ++d0) qr[d0] = *(const bf16x8*)(QNOPE + qrow * 1024 + h * 64 + d0 * 16 + hi * 8);
    {
        const v4u x1 = *(const v4u*)(QROPE + qrow * 512 + h * 32 + hi * 8), x2 = *(const v4u*)(QROPE + qrow * 512 + h * 32 + 16 + hi * 8);
        const float* rp = ROPE + qrow * 32 + hi * 8;
        const f32x4 c0 = *(const f32x4*)rp, c1 = *(const f32x4*)(rp + 4), s0 = *(const f32x4*)(rp + 16), s1 = *(const f32x4*)(rp + 20);
        float a[8], bb[8], cs[8] = {c0[0], c0[1], c0[2], c0[3], c1[0], c1[1], c1[2], c1[3]}, sn[8] = {s0[0], s0[1], s0[2], s0[3], s1[0], s1[1], s1[2], s1[3]};
        a[0] = bf_lo(x1.x); a[1] = bf_hi(x1.x); a[2] = bf_lo(x1.y); a[3] = bf_hi(x1.y); a[4] = bf_lo(x1.z); a[5] = bf_hi(x1.z); a[6] = bf_lo(x1.w); a[7] = bf_hi(x1.w);
        bb[0] = bf_lo(x2.x); bb[1] = bf_hi(x2.x); bb[2] = bf_lo(x2.y); bb[3] = bf_hi(x2.y); bb[4] = bf_lo(x2.z); bb[5] = bf_hi(x2.z); bb[6] = bf_lo(x2.w); bb[7] = bf_hi(x2.w);
        float o1[8], o2[8];
#pragma unroll
        for (int j = 0; j < 8; ++j) { o1[j] = a[j] * cs[j] - bb[j] * sn[j]; o2[j] = a[j] * sn[j] + bb[j] * cs[j]; }
        v4u w1, w2; w1.x = pk2(o1[0], o1[1]); w1.y = pk2(o1[2], o1[3]); w1.z = pk2(o1[4], o1[5]); w1.w = pk2(o1[6], o1[7]);
        w2.x = pk2(o2[0], o2[1]); w2.y = pk2(o2[2], o2[3]); w2.z = pk2(o2[4], o2[5]); w2.w = pk2(o2[6], o2[7]);
        qr[4] = __builtin_bit_cast(bf16x8, w1); qr[5] = __builtin_bit_cast(bf16x8, w2);
    }
    const int skey = tid >> 3, sch = tid & 7;
    const bf16* ksrc = KN + (rowbase + skey) * 1024 + h * 64 + sch * 8;
    const bf16* vsrc = V + (rowbase + skey) * 1024 + h * 64 + sch * 8;
    const bf16* rsrc = KR + (rowbase + (tid >> 2)) * 32 + (tid & 3) * 8;
    const int kdst = skey * KPITCH + sch * 16, rdst = (tid >> 2) * KPITCH + 128 + (tid & 3) * 16;
    const int vdst = KBYTES + (sch >> 2) * 4096 + (skey >> 4) * 1024 + (skey & 15) * 64 + (sch & 3) * 16;
    const int kfrag = r32 * KPITCH + hi * 16;
    const int vfrag = KBYTES + ((lane >> 4) & 1) * 32 + (lane & 3) * 8 + (4 * hi + ((lane & 15) >> 2)) * 64;
    const int NT = 4 * (qb + 1);
    float m_run = -1.0e30f, l_run = 0.f; f32x16 o[2]; o[0] = f32x16{}; o[1] = f32x16{};
    const int qrel = wid * 32 + r32;
    v4u kreg, vreg, rreg = (v4u){0u, 0u, 0u, 0u};
    kreg = *(const v4u*)ksrc; vreg = *(const v4u*)vsrc; if (tid < 256) rreg = *(const v4u*)rsrc;
    *(LAS v4u*)(shm + kdst) = kreg; *(LAS v4u*)(shm + vdst) = vreg; if (tid < 256) *(LAS v4u*)(shm + rdst) = rreg;
    __syncthreads();
    for (int t = 0; t < NT; ++t) {
        LAS unsigned char* buf = shm + (t & 1) * BUFB;
        if (t + 1 < NT) { const size_t adv = (size_t)(t + 1) * 64; kreg = *(const v4u*)(ksrc + adv * 1024); vreg = *(const v4u*)(vsrc + adv * 1024); if (tid < 256) rreg = *(const v4u*)(rsrc + adv * 32); }
        const int jb = t - (NT - 4);
        const bool active = !(jb >= 0 && 64 * jb > wid * 32 + 31);
        if (active) {
            f32x16 p0 = f32x16{}, p1 = f32x16{};
#pragma unroll
            for (int d0 = 0; d0 < 6; ++d0) {
                const bf16x8 k0 = *(const LAS bf16x8*)(buf + kfrag + d0 * 32);
                const bf16x8 k1 = *(const LAS bf16x8*)(buf + kfrag + 32 * KPITCH + d0 * 32);
                p0 = __builtin_amdgcn_mfma_f32_32x32x16_bf16(k0, qr[d0], p0, 0, 0, 0);
                p1 = __builtin_amdgcn_mfma_f32_32x32x16_bf16(k1, qr[d0], p1, 0, 0, 0);
            }
            if (jb >= 0) {
                const int kb = 64 * jb + 4 * hi;
#pragma unroll
                for (int r = 0; r < 16; ++r) { const int kv = kb + (r & 3) + 8 * (r >> 2); if (kv > qrel) p0[r] = -INFINITY; if (kv + 32 > qrel) p1[r] = -INFINITY; }
            }
            float rm = fmaxf(p0[0], p1[0]);
#pragma unroll
            for (int r = 1; r < 16; ++r) rm = fmaxf(rm, fmaxf(p0[r], p1[r]));
            rm = fmaxf(rm, __shfl_xor(rm, 32));
            const float m_new = fmaxf(m_run, rm);
            const float alpha = fast_exp2(m_run - m_new);
            m_run = m_new;
            float sacc = 0.f;
#pragma unroll
            for (int r = 0; r < 16; ++r) { p0[r] = fast_exp2(p0[r] - m_new); p1[r] = fast_exp2(p1[r] - m_new); sacc += p0[r] + p1[r]; }
            l_run = l_run * alpha + sacc;
            if (!__all(alpha == 1.0f)) {
                if (hi == 0) wsf[r32] = alpha;
                LDS_WAIT();
#pragma unroll
                for (int r4 = 0; r4 < 4; ++r4) { const f32x4 f = *(const LAS f32x4*)(wsf + 8 * r4 + 4 * hi);
#pragma unroll
                    for (int e = 0; e < 4; ++e) { o[0][4 * r4 + e] *= f[e]; o[1][4 * r4 + e] *= f[e]; } }
                LDS_WAIT();
            }
            v4u pw[4];
            pw[0] = (v4u){cvt_pk_bf16(p0[0], p0[1]), cvt_pk_bf16(p0[2], p0[3]), cvt_pk_bf16(p0[4], p0[5]), cvt_pk_bf16(p0[6], p0[7])};
            pw[1] = (v4u){cvt_pk_bf16(p0[8], p0[9]), cvt_pk_bf16(p0[10], p0[11]), cvt_pk_bf16(p0[12], p0[13]), cvt_pk_bf16(p0[14], p0[15])};
            pw[2] = (v4u){cvt_pk_bf16(p1[0], p1[1]), cvt_pk_bf16(p1[2], p1[3]), cvt_pk_bf16(p1[4], p1[5]), cvt_pk_bf16(p1[6], p1[7])};
            pw[3] = (v4u){cvt_pk_bf16(p1[8], p1[9]), cvt_pk_bf16(p1[10], p1[11]), cvt_pk_bf16(p1[12], p1[13]), cvt_pk_bf16(p1[14], p1[15])};
#pragma unroll
            for (int d0 = 0; d0 < 2; ++d0)
#pragma unroll
                for (int ks = 0; ks < 4; ++ks) {
                    const s16x4 lo = vtr(buf + vfrag + d0 * 4096 + ks * 1024), hh = vtr(buf + vfrag + d0 * 4096 + ks * 1024 + 512);
                    const bf16x8 vf = (bf16x8){lo[0], lo[1], lo[2], lo[3], hh[0], hh[1], hh[2], hh[3]};
                    o[d0] = __builtin_amdgcn_mfma_f32_32x32x16_bf16(__builtin_bit_cast(bf16x8, pw[ks]), vf, o[d0], 0, 0, 0);
                }
        }
        if (t + 1 < NT) { LAS unsigned char* nb = shm + ((t + 1) & 1) * BUFB; *(LAS v4u*)(nb + kdst) = kreg; *(LAS v4u*)(nb + vdst) = vreg; if (tid < 256) *(LAS v4u*)(nb + rdst) = rreg; }
        __syncthreads();
    }
    l_run += __shfl_xor(l_run, 32);
    if (hi == 0) wsf[r32] = fast_rcp(l_run);
    LDS_WAIT();
    float rli[16];
#pragma unroll
    for (int r = 0; r < 16; ++r) rli[r] = wsf[crow(r, hi)];
    LAS bf16* stg = (LAS bf16*)(shm + LDS_OST) + wid * 2048;
#pragma unroll
    for (int r = 0; r < 16; ++r) { const int orow = crow(r, hi);
#pragma unroll
        for (int d0 = 0; d0 < 2; ++d0) stg[orow * 64 + d0 * 32 + r32] = (bf16)f2bf(o[d0][r] * rli[r]); }
    LDS_WAIT();
    bf16* Ow = O + (rowbase + q0 + wid * 32) * 1024 + h * 64;
#pragma unroll
    for (int i = 0; i < 4; ++i) { const int row = i * 8 + (lane >> 3), ch = lane & 7; const v4u v = *(const LAS v4u*)(stg + row * 64 + ch * 8); *(v4u*)(Ow + (size_t)row * 1024 + ch * 8) = v; }
    LDS_WAIT();
    __syncthreads();
}
}

namespace ssd {
constexpr int CH = 32, NCH = SEQ / CH;
constexpr int O_XS = 0, O_BS = 8192, O_CS = 24576, O_DT = 40960, O_DA = 41088, O_YS = 41216, BUFB = 49408;
static_assert(2 * BUFB <= RING_BYTES, "ssd lds");

__device__ __forceinline__ void unit(int b, int h, const bf16* XBC, const bf16* ZS, const float* DT, const float* conv_w, const float* conv_b, const float* a_log, const float* d_skip, bf16* YG, LAS unsigned char* shm) {
    int tid_ = threadIdx.x; asm volatile("" : "+v"(tid_));
    const int tid = tid_;
    const int g = h >> 3;
    const size_t rowbase = (size_t)b * SEQ;
    const float a_l2 = -__expf(a_log[h]) * LOG2E, Dh = d_skip[h];
    const bool stager = tid < 320;
    const int quad = tid % 80, part = (tid / 80) & 3;
    const int c4 = quad * 4;
    int gcol, ldst;
    if (c4 < 64) { gcol = h * 64 + c4; ldst = O_XS + c4 * 4; }
    else if (c4 < 192) { gcol = 1024 + g * 128 + (c4 - 64); ldst = O_BS + (c4 - 64) * 4; }
    else { gcol = 1280 + g * 128 + (c4 - 192); ldst = O_CS + (c4 - 192) * 4; }
    const int lpitch = (c4 < 64) ? 256 : 512;
    f32x4 cw[4], cb;
#pragma unroll
    for (int k = 0; k < 4; ++k) cw[k] = *(const f32x4*)(conv_w + k * 1536 + gcol);
    cb = *(const f32x4*)(conv_b + gcol);
    const bool dter = tid >= 480; const int dtt = tid - 480;
    const int p = tid >> 3, ns = tid & 7;
    float st[16];
#pragma unroll
    for (int i = 0; i < 16; ++i) st[i] = 0.f;
    v2u pre[11]; float dpre = 0.f;
#define SSD_LOAD(kc) do { const int t0_ = (kc) * CH + part * 8 - 3; \
        if (stager) { _Pragma("unroll") for (int i = 0; i < 11; ++i) { const int ts = t0_ + i; pre[i] = (ts >= 0) ? *(const v2u*)(XBC + (rowbase + ts) * 1536 + gcol) : (v2u){0u, 0u}; } } \
        if (dter) dpre = DT[(rowbase + (kc) * CH + dtt) * 16 + h]; } while (0)
#define SSD_WRITE(bufp) do { \
        if (stager) { f32x4 uu[11]; _Pragma("unroll") for (int i = 0; i < 11; ++i) uu[i] = (f32x4){bf_lo(pre[i].x), bf_hi(pre[i].x), bf_lo(pre[i].y), bf_hi(pre[i].y)}; \
            _Pragma("unroll") for (int r = 0; r < 8; ++r) { f32x4 v = cb + cw[0] * uu[r] + cw[1] * uu[r + 1] + cw[2] * uu[r + 2] + cw[3] * uu[r + 3]; \
                _Pragma("unroll") for (int e = 0; e < 4; ++e) v[e] = silu_f(v[e]); \
                *(LAS f32x4*)((bufp) + ldst + (part * 8 + r) * lpitch) = v; } } \
        if (dter) { *(LAS float*)((bufp) + O_DT + dtt * 4) = dpre; *(LAS float*)((bufp) + O_DA + dtt * 4) = fast_exp2(dpre * a_l2); } } while (0)
#define SSD_OUT(kc, bufp) do { const int row_ = tid >> 4, cc_ = (tid & 15) * 4; const size_t gr_ = rowbase + (size_t)(kc) * CH + row_; \
        const f32x4 y_ = *(const LAS f32x4*)((bufp) + O_YS + (row_ * 64 + cc_) * 4); const v2u z_ = *(const v2u*)(ZS + gr_ * 1024 + h * 64 + cc_); \
        v2u w_; w_.x = pk2(y_[0] * bf_lo(z_.x), y_[1] * bf_hi(z_.x)); w_.y = pk2(y_[2] * bf_lo(z_.y), y_[3] * bf_hi(z_.y)); \
        *(v2u*)(YG + gr_ * 1024 + h * 64 + cc_) = w_; } while (0)
    SSD_LOAD(0); SSD_WRITE(shm);
    __syncthreads();
    for (int kc = 0; kc < NCH; ++kc) {
        LAS unsigned char* buf = shm + (kc & 1) * BUFB;
        LAS unsigned char* obuf = shm + ((kc + 1) & 1) * BUFB;
        if (kc + 1 < NCH) SSD_LOAD(kc + 1);
        if (kc > 0) SSD_OUT(kc - 1, obuf);
        const LAS float* xs = (const LAS float*)(buf + O_XS) + p;
        const LAS float* Bs = (const LAS float*)(buf + O_BS) + ns * 16;
        const LAS float* Cs = (const LAS float*)(buf + O_CS) + ns * 16;
        const LAS float* dts = (const LAS float*)(buf + O_DT);
        const LAS float* das = (const LAS float*)(buf + O_DA);
        LAS float* ys = (LAS float*)(buf + O_YS) + p;
#pragma unroll 2
        for (int t = 0; t < CH; ++t) {
            const float xv = xs[t * 64], dA = das[t], dtx = dts[t] * xv;
            float acc = 0.f;
#pragma unroll
            for (int i4 = 0; i4 < 4; ++i4) { const f32x4 bv = *(const LAS f32x4*)(Bs + t * 128 + i4 * 4), cv = *(const LAS f32x4*)(Cs + t * 128 + i4 * 4);
#pragma unroll
                for (int e = 0; e < 4; ++e) { st[i4 * 4 + e] = st[i4 * 4 + e] * dA + dtx * bv[e]; acc += cv[e] * st[i4 * 4 + e]; } }
            acc += __shfl_xor(acc, 1); acc += __shfl_xor(acc, 2); acc += __shfl_xor(acc, 4);
            if (ns == 0) ys[t * 64] = acc + Dh * xv;
        }
        if (kc + 1 < NCH) SSD_WRITE(obuf);
        __syncthreads();
    }
    SSD_OUT(NCH - 1, shm + ((NCH - 1) & 1) * BUFB);
    __syncthreads();
#undef SSD_LOAD
#undef SSD_WRITE
#undef SSD_OUT
}
}

#define XB_TMO      128
#define XB_XCNT(j)  (256  + 64 * (j))
#define XB_XSUB(j)  (1280 + 64 * (j))
#define XB_XGEN(j)  (2304 + 64 * (j))
#define XB_TOP      3328
#define XB_TOPGEN   3392
#define XCD_BAR_WORDS 3456
#define XB_SPIN_CAP (1u << 22)
__device__ __forceinline__ unsigned xb_ld(unsigned* p)              { return __hip_atomic_load(p, __ATOMIC_RELAXED, __HIP_MEMORY_SCOPE_AGENT); }
__device__ __forceinline__ unsigned xb_add(unsigned* p, unsigned v) { return __hip_atomic_fetch_add(p, v, __ATOMIC_RELAXED, __HIP_MEMORY_SCOPE_AGENT); }
__device__ __forceinline__ unsigned xb_xcc_id() { return (unsigned)__builtin_amdgcn_s_getreg((3 << 11) | 20) & 0xFu; }
#define XB_SPIN(cond, bar) do { unsigned _sp = 0; while (cond) { __builtin_amdgcn_s_sleep(1); \
    if ((++_sp & 255u) == 0u) { if (xb_ld(&(bar)[XB_TMO])) break; if (_sp > XB_SPIN_CAP) { atomicAdd(&(bar)[XB_TMO], 1u); break; } } } } while (0)
struct XcdBarrier { unsigned* bar; unsigned x; volatile LAS unsigned* st; };
__device__ __forceinline__ XcdBarrier xcd_barrier_post(unsigned* bar, volatile LAS unsigned* st) {
    XcdBarrier b; b.bar = bar; b.x = xb_xcc_id(); b.st = st;
    if (threadIdx.x == 0) (void)xb_add(&bar[XB_XCNT(b.x)], 1u);
    return b;
}
__device__ __forceinline__ void xcd_barrier_complete(unsigned* bar, unsigned x, unsigned& nloc, unsigned& nx) {
    const unsigned G = gridDim.x * gridDim.y * gridDim.z;
    unsigned sum, cnt, mine, sp = 0u;
    for (;;) {
        sum = 0u; cnt = 0u; mine = 0u;
#pragma unroll
        for (unsigned j = 0; j < 16; ++j) { const unsigned c = xb_ld(&bar[XB_XCNT(j)]); sum += c; cnt += (c > 0u) ? 1u : 0u; mine = (j == x) ? c : mine; }
        if (sum == G) break;
        __builtin_amdgcn_s_sleep(1);
        if ((++sp & 255u) == 0u) { if (xb_ld(&bar[XB_TMO])) break; if (sp > XB_SPIN_CAP) { atomicAdd(&bar[XB_TMO], 1u); break; } }
    }
    nloc = mine > 0u ? mine : 1u; nx = cnt > 0u ? cnt : 1u;
}
__device__ __forceinline__ void xcd_barrier(const XcdBarrier& b) {
    asm volatile("s_waitcnt vmcnt(0)" ::: "memory");
    __syncthreads();
    if (threadIdx.x == 0) {
        unsigned* bar = b.bar;
        __builtin_amdgcn_s_waitcnt(0);
        unsigned nloc = b.st[0], nx = b.st[1];
        if (nloc == 0u) { xcd_barrier_complete(bar, b.x, nloc, nx); b.st[0] = nloc; b.st[1] = nx; }
        const unsigned old = xb_add(&bar[XB_XSUB(b.x)], 1u);
        const unsigned gen = old / nloc;
        if (old + 1u == (gen + 1u) * nloc) {
            __builtin_amdgcn_fence(__ATOMIC_RELEASE, "agent");
            asm volatile("s_waitcnt vmcnt(0)" ::: "memory");
            const unsigned og = xb_add(&bar[XB_TOP], 1u);
            const unsigned tg = og / nx;
            if (og + 1u == (tg + 1u) * nx) xb_add(&bar[XB_TOPGEN], 1u);
            else XB_SPIN(xb_ld(&bar[XB_TOPGEN]) == tg, bar);
            __builtin_amdgcn_fence(__ATOMIC_ACQUIRE, "agent");
            xb_add(&bar[XB_XGEN(b.x)], 1u);
            asm volatile("s_waitcnt vmcnt(0)" ::: "memory");
        } else {
            XB_SPIN(xb_ld(&bar[XB_XGEN(b.x)]) == gen, bar);
            __builtin_amdgcn_fence(__ATOMIC_ACQUIRE, "agent");
            asm volatile("s_waitcnt vmcnt(0)" ::: "memory");
        }
    }
    __syncthreads();
}

struct Args { const float* in[38]; float* out; unsigned char* ws; int ph_lo, ph_hi; };
struct Frame {
    LAS unsigned char* lds;
    int tid, lane, wave, vcu, G;
};

__device__ __forceinline__ void cvt_item(const float* W, int ldn, int K, int src_col, int nvalid, bf16* WT, int dst_row, LAS float* scr, int kb, int lane) {
    const int k0 = 64 * kb, c = lane & 31;
#pragma unroll 8
    for (int i = 0; i < 32; ++i) { const int kk = 2 * i + (lane >> 5); scr[kk * 33 + c] = (c < nvalid) ? W[(size_t)(k0 + kk) * ldn + src_col + c] : 0.f; }
    LDS_WAIT(); asm volatile("" ::: "memory");
    const int c8 = lane & 7;
#pragma unroll
    for (int j = 0; j < 4; ++j) { const int n = (lane >> 3) + 8 * j; const LAS float* s = scr + (8 * c8) * 33 + n;
        v4u o; o.x = pk2(s[0 * 33], s[1 * 33]); o.y = pk2(s[2 * 33], s[3 * 33]); o.z = pk2(s[4 * 33], s[5 * 33]); o.w = pk2(s[6 * 33], s[7 * 33]);
        *(v4u*)(WT + (size_t)(dst_row + n) * K + k0 + 8 * c8) = o; }
    LDS_WAIT(); asm volatile("" ::: "memory");
}
__device__ __forceinline__ void cvt_segment(Frame& F, LAS float* scr, unsigned& cum, const float* W, int ldn, int K, int nblk, int mode, int col0, int nvalid_total, bf16* WT, int row0) {
    const int gw = F.vcu * NWAVES + F.wave, NGW = F.G * NWAVES;
    const int items = (K / 64) * nblk;
    int it = (int)(((unsigned)gw + (unsigned)NGW - (cum % (unsigned)NGW)) % (unsigned)NGW);
    for (; it < items; it += NGW) {
        const int kb = it / nblk, j = it % nblk;
        int src_col, dst_row, nvalid = 32;
        if (mode == 0) { src_col = col0 + 32 * j; dst_row = row0 + 32 * j; nvalid = nvalid_total - 32 * j; nvalid = nvalid < 0 ? 0 : (nvalid > 32 ? 32 : nvalid); }
        else if (mode == 1) { const int n = 32 * j; src_col = n; dst_row = (n >> 7) * 256 + row0 + (n & 127); }
        else { const int hh = j / 3, part = j % 3; src_col = 32 * j; dst_row = part < 2 ? hh * 64 + part * 32 : 1024 + hh * 32; }
        cvt_item(W, ldn, K, src_col, nvalid, WT, dst_row, scr, kb, F.lane);
    }
    cum += (unsigned)items;
}
template <bool HAS_H, bool HAS_XN>
__device__ __forceinline__ void rowpass(Frame& F, int nrows, const float* xin, float* xout, const bf16* H, const float* g_post, float w, const float* g_pre, bf16* XN) {
    const int gw = F.vcu * NWAVES + F.wave, NGW = F.G * NWAVES;
    for (int m = gw; m < nrows; m += NGW) {
        const f32x4* xr = (const f32x4*)(xin + (size_t)m * DM) + F.lane;
        f32x4 v[4];
#pragma unroll
        for (int j = 0; j < 4; ++j) v[j] = xr[64 * j];
        if (HAS_H) {
            const v2u* hr = (const v2u*)(H + (size_t)m * DM) + F.lane;
            f32x4 hv[4]; float s = 0.f;
#pragma unroll
            for (int j = 0; j < 4; ++j) { const v2u q = hr[64 * j]; hv[j] = (f32x4){bf_lo(q.x), bf_hi(q.x), bf_lo(q.y), bf_hi(q.y)}; s += (hv[j].x * hv[j].x + hv[j].y * hv[j].y) + (hv[j].z * hv[j].z + hv[j].w * hv[j].w); }
            const float rs = w / sqrtf(wave_sum(s) * (1.f / DM) + EPS);
#pragma unroll
            for (int j = 0; j < 4; ++j) { const f32x4 gp = ((const f32x4*)g_post)[F.lane + 64 * j]; v[j] += hv[j] * gp * rs; }
            f32x4* xo = (f32x4*)(xout + (size_t)m * DM) + F.lane;
#pragma unroll
            for (int j = 0; j < 4; ++j) xo[64 * j] = v[j];
        }
        if (HAS_XN) {
            float s2 = 0.f;
#pragma unroll
            for (int j = 0; j < 4; ++j) s2 += (v[j].x * v[j].x + v[j].y * v[j].y) + (v[j].z * v[j].z + v[j].w * v[j].w);
            const float rs2 = 1.f / sqrtf(wave_sum(s2) * (1.f / DM) + EPS);
            v2u* o8 = (v2u*)(XN + (size_t)m * DM) + F.lane;
#pragma unroll
            for (int j = 0; j < 4; ++j) { const f32x4 gp = ((const f32x4*)g_pre)[F.lane + 64 * j]; const f32x4 y = v[j] * gp * rs2; v2u q; q.x = pk2(y.x, y.y); q.y = pk2(y.z, y.w); o8[64 * j] = q; }
        }
    }
}

__global__ void __launch_bounds__(NWAVES * 64, 2) mega_fwd(Args args) {
    extern __shared__ __attribute__((aligned(16))) unsigned char lds_raw[];
    Frame F;
    F.lds = (LAS unsigned char*)lds_raw;
    volatile LAS unsigned* MISCW = (volatile LAS unsigned*)(F.lds + MISC_OFF);
    F.tid = threadIdx.x; F.lane = F.tid & 63; F.wave = __builtin_amdgcn_readfirstlane(F.tid >> 6);
    F.G = gridDim.x; { const int bx = blockIdx.x; F.vcu = (F.G % 8 == 0) ? (bx % 8) * (F.G / 8) + bx / 8 : bx; }
    unsigned char* ws = args.ws;
    unsigned* ctl = (unsigned*)(ws + WS_CTL);
    for (int u = F.tid; u < (LDS_BYTES - LDSCTL_OFF) / 4; u += NWAVES * 64) ((LAS unsigned*)(F.lds + LDSCTL_OFF))[u] = 0u;
    __syncthreads();
    XcdBarrier bar = xcd_barrier_post(ctl + CW_BAR, MISCW + 8);
    const int lo = args.ph_lo, hi = args.ph_hi;
#ifndef PHASE_MASK
#define PHASE_MASK 0x1fffff
#endif
#define IN(k) ((((PHASE_MASK) >> (k)) & 1) && lo <= (k) && (k) < hi)
#define SEAM(k) do { if (IN(k) && IN((k) + 1)) xcd_barrier(bar); F.tid = threadIdx.x; asm volatile("" : "+v"(F.tid)); F.lane = F.tid & 63; } while (0)

    const float* x = args.in[0]; const float* mem = args.in[1]; const int* positions = (const int*)args.in[2];
    float* out = args.out;
    float* ROPE = (float*)(ws + WS_ROPE); bf16* MEMN = (bf16*)(ws + WS_MEMN); bf16* MK = (bf16*)(ws + WS_MK); bf16* MVT = (bf16*)(ws + WS_MVT);
    float* DT = (float*)(ws + WS_DT); bf16* KR = (bf16*)(ws + WS_KR);
    bf16* XN = (bf16*)(ws + WS_XN); bf16* HID = (bf16*)(ws + WS_HID); bf16* ZS = (bf16*)(ws + WS_ZS); bf16* XBC = (bf16*)(ws + WS_XBC); float* MISC = (float*)(ws + WS_MISC);
    bf16* QN = (bf16*)(ws + WS_QN); bf16* KVN = (bf16*)(ws + WS_KVN); bf16* YG = (bf16*)(ws + WS_YG);
    bf16* QNOPE = (bf16*)(ws + WS_QNOPE); bf16* KN = (bf16*)(ws + WS_KN); bf16* VV = (bf16*)(ws + WS_V); bf16* QROPE = (bf16*)(ws + WS_QROPE);
    bf16* GG = (bf16*)(ws + WS_G); bf16* MERGED = (bf16*)(ws + WS_MERGED); bf16* QX = (bf16*)(ws + WS_QX); bf16* PP = (bf16*)(ws + WS_P); bf16* OX = (bf16*)(ws + WS_OX);
    bf16* Wgu1 = (bf16*)(ws + W_GU1); bf16* Wd1 = (bf16*)(ws + W_D1); bf16* Win = (bf16*)(ws + W_IN); bf16* Wg = (bf16*)(ws + W_G);
    bf16* Wssd = (bf16*)(ws + W_SSD); bf16* Wmla = (bf16*)(ws + W_MLA); bf16* Wout = (bf16*)(ws + W_OUT);
    bf16* Wxq = (bf16*)(ws + W_XQ); bf16* Wxk = (bf16*)(ws + W_XK); bf16* Wxv = (bf16*)(ws + W_XV); bf16* Wxo = (bf16*)(ws + W_XO);
    bf16* Wuq = (bf16*)(ws + W_UQ); bf16* Wukv = (bf16*)(ws + W_UKV); bf16* Wgu2 = (bf16*)(ws + W_GU2); bf16* Wd2 = (bf16*)(ws + W_D2);
    const int gw = F.vcu * NWAVES + F.wave, NGW = F.G * NWAVES;

    if (IN(0)) {
        LAS float* scr = (LAS float*)(F.lds + F.wave * 16384);
        unsigned cum = 0u;
        cvt_segment(F, scr, cum, args.in[4], DFF, 1024, 88, 1, 0, 0, Wgu1, 0);
        cvt_segment(F, scr, cum, args.in[5], DFF, 1024, 88, 1, 0, 0, Wgu1, 128);
        cvt_segment(F, scr, cum, args.in[6], 1024, DFF, 32, 0, 0, 1024, Wd1, 0);
        cvt_segment(F, scr, cum, args.in[9], 5296, 1024, 80, 0, 0, 2560, Win, 0);
        cvt_segment(F, scr, cum, args.in[9], 5296, 1024, 21, 0, 2576, 672, Win, 2560);
        cvt_segment(F, scr, cum, args.in[9], 5296, 1024, 3, 0, 2560, 16, Win, 3232);
        cvt_segment(F, scr, cum, args.in[9], 5296, 1024, 64, 0, 3248, 2048, Wg, 0);
        cvt_segment(F, scr, cum, args.in[16], 1024, 1024, 32, 0, 0, 1024, Wssd, 0);
        cvt_segment(F, scr, cum, args.in[22], 1024, 1024, 32, 0, 0, 1024, Wmla, 0);
        cvt_segment(F, scr, cum, args.in[24], 1024, 1024, 32, 0, 0, 1024, Wout, 0);
        cvt_segment(F, scr, cum, args.in[28], 1024, 1024, 32, 0, 0, 1024, Wxq, 0);
        cvt_segment(F, scr, cum, args.in[29], 1024, 1024, 32, 0, 0, 1024, Wxk, 0);
        cvt_segment(F, scr, cum, args.in[30], 1024, 1024, 32, 0, 0, 1024, Wxv, 0);
        cvt_segment(F, scr, cum, args.in[31], 1024, 1024, 32, 0, 0, 1024, Wxo, 0);
        cvt_segment(F, scr, cum, args.in[18], 1536, 384, 48, 2, 0, 0, Wuq, 0);
        cvt_segment(F, scr, cum, args.in[20], 1024, 256, 32, 0, 0, 1024, Wukv, 0);
        cvt_segment(F, scr, cum, args.in[21], 1024, 256, 32, 0, 0, 1024, Wukv, 1024);
        cvt_segment(F, scr, cum, args.in[34], DFF, 1024, 88, 1, 0, 0, Wgu2, 0);
        cvt_segment(F, scr, cum, args.in[35], DFF, 1024, 88, 1, 0, 0, Wgu2, 128);
        cvt_segment(F, scr, cum, args.in[36], 1024, DFF, 32, 0, 0, 1024, Wd2, 0);
        {
            const double INVF[16] = {0.15915494309189535, 0.08949940160889101, 0.050329212104487035, 0.0283021958306234, 0.015915494309189534, 0.008949940160889102, 0.005032921210448704, 0.00283021958306234,
                                     0.0015915494309189536, 0.0008949940160889102, 0.0005032921210448703, 0.00028302195830623395, 0.00015915494309189535, 8.949940160889102e-05, 5.0329212104487035e-05, 2.8302195830623396e-05};
            const int i = F.tid & 15; double fsel = INVF[0];
#pragma unroll
            for (int k = 1; k < 16; ++k) fsel = (i == k) ? INVF[k] : fsel;
            for (int idx = F.vcu * 512 + F.tid; idx < T * 16; idx += F.G * 512) {
                const int t = idx >> 4; const double rev = (double)positions[t] * fsel; const float fr = (float)(rev - __builtin_floor(rev));
                ROPE[(size_t)t * 32 + i] = __builtin_amdgcn_cosf(fr); ROPE[(size_t)t * 32 + 16 + i] = __builtin_amdgcn_sinf(fr);
            }
        }
        rowpass<false, true>(F, T, x, nullptr, nullptr, nullptr, 0.f, args.in[3], XN);
        rowpass<false, true>(F, MROWS, mem, nullptr, nullptr, nullptr, 0.f, args.in[27], MEMN);
    }
    SEAM(0);
    if (IN(1)) {
        { pg8::Gemm g{XN, Wgu1, 1024, 1024, 1024}; pg8::StaticOrder S; S.init(T, 5632, F.G, (int)blockIdx.x, 1024, 1024); pg8::EpiSwiGLU E{HID, DFF};
          pg8::gemm_phase<pg8::EpiSwiGLU, pg8::StaticOrder, true>(F.lds, g, S, E); }
        { pg8::Gemm g{MEMN, Wxk, 1024, 1024, 1024}; pg8::StaticOrder S; S.init(MROWS, 1024, F.G, (int)blockIdx.x, 1024, 1024); pg8::EpiBf16 E{MK, 1024, MK, 1024, 1 << 20, MK, 1024, 1 << 20, 1.0f};
          pg8::gemm_phase<pg8::EpiBf16, pg8::StaticOrder, true>(F.lds, g, S, E); }
        { pg8::Gemm g{Wxv, MEMN, 1024, 1024, 1024}; pg8::StaticOrder S; S.init(1024, MROWS, F.G, (int)blockIdx.x, 1024, 1024); pg8::EpiBf16 E{MVT, 4096, MVT, 4096, 1 << 20, MVT, 4096, 1 << 20, 1.0f};
          pg8::gemm_phase<pg8::EpiBf16, pg8::StaticOrder, true>(F.lds, g, S, E); }
    }
    SEAM(1);
    if (IN(2)) {
        pg8::Gemm g{HID, Wd1, DFF, DFF, DFF}; pg8::StaticOrder S; S.init(T, 1024, F.G, (int)blockIdx.x, DFF, DFF); pg8::EpiBf16 E{XN, 1024, XN, 1024, 1 << 20, XN, 1024, 1 << 20, 1.0f};
        pg8::gemm_phase<pg8::EpiBf16, pg8::StaticOrder, true>(F.lds, g, S, E);
    }
    SEAM(2);
    if (IN(3)) rowpass<true, true>(F, T, x, out, XN, args.in[7], 0.5f, args.in[8], XN);
    SEAM(3);
    if (IN(4)) {
        pg8::Gemm g{XN, Win, 1024, 1024, 1024}; pg8::StaticOrder S; S.init(T, NWIN, F.G, (int)blockIdx.x, 1024, 1024); pg8::EpiWin E{ZS, XBC, MISC};
        pg8::gemm_phase<pg8::EpiWin, pg8::StaticOrder, true>(F.lds, g, S, E);
    }
    SEAM(4);
    if (IN(5)) {
        const float* qg = args.in[17]; const float* kvg = args.in[19]; const float* dtb = args.in[12];
        for (int m = gw; m < T; m += NGW) {
            const float* r = MISC + (size_t)m * MISC_LD;
            float q[6], s = 0.f;
#pragma unroll
            for (int j = 0; j < 6; ++j) { q[j] = r[F.lane + 64 * j]; s += q[j] * q[j]; }
            const float rs = 1.f / sqrtf(wave_sum(s) * (1.f / 384.f) + EPS);
#pragma unroll
            for (int j = 0; j < 6; ++j) QN[(size_t)m * 384 + F.lane + 64 * j] = (bf16)f2bf(q[j] * rs * qg[F.lane + 64 * j]);
            float kv[4], s2 = 0.f;
#pragma unroll
            for (int j = 0; j < 4; ++j) { kv[j] = r[384 + F.lane + 64 * j]; s2 += kv[j] * kv[j]; }
            const float rs2 = 1.f / sqrtf(wave_sum(s2) * (1.f / 256.f) + EPS);
#pragma unroll
            for (int j = 0; j < 4; ++j) KVN[(size_t)m * 256 + F.lane + 64 * j] = (bf16)f2bf(kv[j] * rs2 * kvg[F.lane + 64 * j]);
            if (F.lane < 16) {
                const float x1 = r[640 + F.lane], x2 = r[656 + F.lane], cs = ROPE[(size_t)m * 32 + F.lane], sn = ROPE[(size_t)m * 32 + 16 + F.lane];
                KR[(size_t)m * 32 + F.lane] = (bf16)f2bf(x1 * cs - x2 * sn); KR[(size_t)m * 32 + 16 + F.lane] = (bf16)f2bf(x1 * sn + x2 * cs);
            } else if (F.lane < 32) {
                const int hh = F.lane - 16; const float v = r[672 + hh] + dtb[hh];
                DT[(size_t)m * 16 + hh] = fmaxf(v, 0.f) + log1pf(__expf(-fabsf(v)));
            }
        }
    }
    SEAM(5);
    if (IN(6)) {
        for (int u = F.vcu; u < BATCH * 16; u += F.G)
            ssd::unit(u >> 4, u & 15, XBC, ZS, DT, args.in[10], args.in[11], args.in[13], args.in[14], YG, F.lds);
    }
    SEAM(6);
    if (IN(7)) {
        { pg8::Gemm g{QN, Wuq, 384, 384, 384}; pg8::StaticOrder S; S.init(T, 1536, F.G, (int)blockIdx.x, 384, 384); pg8::EpiBf16 E{QNOPE, 1024, QROPE, 512, 4, QROPE, 512, 1 << 20, C2_MLA};
          pg8::gemm_phase<pg8::EpiBf16, pg8::StaticOrder, true>(F.lds, g, S, E); }
        { pg8::Gemm g{KVN, Wukv, 256, 256, 256}; pg8::StaticOrder S; S.init(T, 2048, F.G, (int)blockIdx.x, 256, 256); pg8::EpiBf16 E{KN, 1024, VV, 1024, 4, VV, 1024, 1 << 20, 1.0f};
          pg8::gemm_phase<pg8::EpiBf16, pg8::StaticOrder, true>(F.lds, g, S, E); }
    }
    SEAM(7);
    if (IN(8)) {
        for (int u = F.vcu; u < BATCH * 16; u += F.G)
            for (int qb = 0; qb < 8; ++qb) mla::attn_unit(u >> 4, u & 15, qb, QNOPE, QROPE, KN, KR, VV, ROPE, QNOPE, F.lds);
        const float* sg = args.in[15];
        for (int m = gw; m < T; m += NGW) {
            v4u* yr = (v4u*)(YG + (size_t)m * DM) + F.lane;
#pragma unroll
            for (int j = 0; j < 2; ++j) {
                const v4u q = yr[64 * j]; f32x4 v0, v1; pg8::unpack8(q, v0, v1);
                float s = (v0[0] * v0[0] + v0[1] * v0[1]) + (v0[2] * v0[2] + v0[3] * v0[3]) + (v1[0] * v1[0] + v1[1] * v1[1]) + (v1[2] * v1[2] + v1[3] * v1[3]);
                const float rs = 1.f / sqrtf(wave_sum(s) * (1.f / 512.f) + EPS);
                const f32x4 g0 = *(const f32x4*)(sg + 512 * j + 8 * F.lane), g1 = *(const f32x4*)(sg + 512 * j + 8 * F.lane + 4);
                yr[64 * j] = pg8::pack8(v0 * g0 * rs, v1 * g1 * rs);
            }
        }
    }
    SEAM(8);
    if (IN(9)) {
        pg8::Gemm g{XN, Wg, 1024, 1024, 1024}; pg8::StaticOrder S; S.init(T, 2048, F.G, (int)blockIdx.x, 1024, 1024); pg8::EpiGate E{GG, args.in[23]};
        pg8::gemm_phase<pg8::EpiGate, pg8::StaticOrder, true>(F.lds, g, S, E);
    }
    SEAM(9);
    if (IN(10)) {
        { pg8::Gemm g{YG, Wssd, 1024, 1024, 1024}; pg8::StaticOrder S; S.init(T, 1024, F.G, (int)blockIdx.x, 1024, 1024); pg8::EpiMerge<false> E{MERGED, GG, 0};
          pg8::gemm_phase<pg8::EpiMerge<false>, pg8::StaticOrder, true>(F.lds, g, S, E); }
        { pg8::Gemm g{QNOPE, Wmla, 1024, 1024, 1024}; pg8::StaticOrder S; S.init(T, 1024, F.G, (int)blockIdx.x, 1024, 1024); pg8::EpiMerge<true> E{MERGED, GG, 1024};
          pg8::gemm_phase<pg8::EpiMerge<true>, pg8::StaticOrder, true>(F.lds, g, S, E); }
    }
    SEAM(10);
    if (IN(11)) {
        pg8::Gemm g{MERGED, Wout, 1024, 1024, 1024}; pg8::StaticOrder S; S.init(T, 1024, F.G, (int)blockIdx.x, 1024, 1024); pg8::EpiBf16 E{XN, 1024, XN, 1024, 1 << 20, XN, 1024, 1 << 20, 1.0f};
        pg8::gemm_phase<pg8::EpiBf16, pg8::StaticOrder, true>(F.lds, g, S, E);
    }
    SEAM(11);
    if (IN(12)) rowpass<true, true>(F, T, out, out, XN, args.in[25], 1.0f, args.in[26], XN);
    SEAM(12);
    if (IN(13)) {
        pg8::Gemm g{XN, Wxq, 1024, 1024, 1024}; pg8::StaticOrder S; S.init(T, 1024, F.G, (int)blockIdx.x, 1024, 1024); pg8::EpiBf16 E{QX, 1024, QX, 1024, 1 << 20, QX, 1024, 1 << 20, C2_XA};
        pg8::gemm_phase<pg8::EpiBf16, pg8::StaticOrder, true>(F.lds, g, S, E);
    }
    SEAM(13);
    if (IN(14)) {
        pg8::Gemm g{QX, MK, 1024, 1024, 256}; pg8::EpiSoftmax E{PP};
        for (int i = 0; i * F.G + F.vcu < 512; ++i) {
            struct One { pg8::XaOrder<0> o; int i0; __device__ bool next(int i, pg8::Unit& u) const { return i == 0 ? o.next(i0, u) : false; } } S{{F.G, F.vcu}, i};
            pg8::gemm_phase<pg8::EpiSoftmax, One, false>(F.lds, g, S, E);
        }
    }
    SEAM(14);
    if (IN(15)) {
        pg8::Gemm g{PP, MVT, 1024, 4096, 256}; pg8::XaOrder<1> S{F.G, F.vcu}; pg8::EpiBf16 E{OX, 1024, OX, 1024, 1 << 20, OX, 1024, 1 << 20, 1.0f};
        pg8::gemm_phase<pg8::EpiBf16, pg8::XaOrder<1>, true>(F.lds, g, S, E);
    }
    SEAM(15);
    if (IN(16)) {
        pg8::Gemm g{OX, Wxo, 1024, 1024, 1024}; pg8::StaticOrder S; S.init(T, 1024, F.G, (int)blockIdx.x, 1024, 1024); pg8::EpiBf16 E{XN, 1024, XN, 1024, 1 << 20, XN, 1024, 1 << 20, 1.0f};
        pg8::gemm_phase<pg8::EpiBf16, pg8::StaticOrder, true>(F.lds, g, S, E);
    }
    SEAM(16);
    if (IN(17)) rowpass<true, true>(F, T, out, out, XN, args.in[32], 1.0f, args.in[33], XN);
    SEAM(17);
    if (IN(18)) {
        pg8::Gemm g{XN, Wgu2, 1024, 1024, 1024}; pg8::StaticOrder S; S.init(T, 5632, F.G, (int)blockIdx.x, 1024, 1024); pg8::EpiSwiGLU E{HID, DFF};
        pg8::gemm_phase<pg8::EpiSwiGLU, pg8::StaticOrder, true>(F.lds, g, S, E);
    }
    SEAM(18);
    if (IN(19)) {
        pg8::Gemm g{HID, Wd2, DFF, DFF, DFF}; pg8::StaticOrder S; S.init(T, 1024, F.G, (int)blockIdx.x, DFF, DFF); pg8::EpiBf16 E{XN, 1024, XN, 1024, 1 << 20, XN, 1024, 1 << 20, 1.0f};
        pg8::gemm_phase<pg8::EpiBf16, pg8::StaticOrder, true>(F.lds, g, S, E);
    }
    SEAM(19);
    if (IN(20)) rowpass<true, false>(F, T, out, out, XN, args.in[37], 0.5f, nullptr, nullptr);
#undef IN
#undef SEAM
}

#ifndef MK_SPLIT
#define MK_SPLIT 0
#endif
constexpr int N_PHASES = 21;
extern "C" void kernel_launch(void* const* d_in, const int* in_sizes, int n_in, void* d_out, int out_size, void* d_ws, size_t ws_size, hipStream_t stream) {
    static int grid = 0;
    if (grid == 0) {
        if (n_in != 38 || out_size != T * DM || ws_size < WS_END) { fprintf(stderr, "kernel_launch: unexpected problem (n_in %d, out %d, ws %zu)\n", n_in, out_size, ws_size); grid = -1; return; }
        int dev = 0, cus = 0, per_cu = 0;
        if (hipGetDevice(&dev) != hipSuccess || hipDeviceGetAttribute(&cus, hipDeviceAttributeMultiprocessorCount, dev) != hipSuccess) { grid = -1; return; }
        if (hipFuncSetAttribute((const void*)mega_fwd, hipFuncAttributeMaxDynamicSharedMemorySize, LDS_BYTES) != hipSuccess) { fprintf(stderr, "kernel_launch: hipFuncSetAttribute failed\n"); grid = -1; return; }
        if (hipOccupancyMaxActiveBlocksPerMultiprocessor(&per_cu, (const void*)mega_fwd, NWAVES * 64, LDS_BYTES) != hipSuccess || per_cu < 1) { fprintf(stderr, "kernel_launch: occupancy query says %d blocks per CU\n", per_cu); grid = -1; (void)hipGetLastError(); return; }
        grid = cus;
    }
    if (grid < 0) return;
    (void)hipMemsetAsync((char*)d_ws + WS_CTL, 0, CTL_ZERO_BYTES, stream);
    Args a{};
    for (int i = 0; i < 38; ++i) a.in[i] = (const float*)d_in[i];
    a.out = (float*)d_out; a.ws = (unsigned char*)d_ws;
#if MK_SPLIT
    for (int p = 0; p < N_PHASES; ++p) { a.ph_lo = p; a.ph_hi = p + 1; hipLaunchKernelGGL(mega_fwd, dim3(grid), dim3(NWAVES * 64), LDS_BYTES, stream, a); }
#else
    a.ph_lo = 0; a.ph_hi = N_PHASES;
    void* kargs[] = {&a};
    hipError_t e = hipLaunchCooperativeKernel((const void*)mega_fwd, dim3(grid), dim3(NWAVES * 64), kargs, LDS_BYTES, stream);
    if (e != hipSuccess) fprintf(stderr, "kernel_launch: cooperative launch failed: %s\n", hipGetErrorString(e));
#endif
}
```
